# Optimizing an MI355X kernel written in HIP

```python
import math
import jax, jax.numpy as jnp
from jax import lax
import numpy as np

D_MODEL = 1024
BATCH = 8
SEQ = 2048
DEPTH = 1

CHUNK = 64
Q_BLOCK = 128
HEAD_DIM = 64
N_HEADS_DIFF = D_MODEL // 256
DIFF_V_DIM = 2 * HEAD_DIM
N_HEADS_CHUNK = D_MODEL // 128
LEFT_CHUNKS = 8
BAND = (LEFT_CHUNKS + 1) * CHUNK
REL_CLIP = 128
N_MEM = 256
N_HEADS_MEM = 4
MEM_HEAD_DIM = D_MODEL // N_HEADS_MEM
D_FF = 4 * D_MODEL
ROPE_THETA = 10000.0
LN_EPS = 1e-5
NEG_INF = -1e30
DEEPNORM_ALPHA = (2.0 * DEPTH) ** 0.25
DEEPNORM_BETA = (8.0 * DEPTH) ** -0.25

W_DIFF_QK = N_HEADS_DIFF * 2 * HEAD_DIM
W_DIFF_V = N_HEADS_DIFF * DIFF_V_DIM
W_CHUNK = N_HEADS_CHUNK * HEAD_DIM
MIX_WIDTH = W_DIFF_V + W_CHUNK
IN_SPLITS = [W_DIFF_QK, W_DIFF_QK, W_DIFF_V, W_CHUNK, W_CHUNK, W_CHUNK]
IN_WIDTH = sum(IN_SPLITS)

kernel_name = "hybrid_diffattn_chunkrel_stream_layer"


def layer_norm(x, g, b):
    xf = x.astype(jnp.float32)
    mu = jnp.mean(xf, axis=-1, keepdims=True)
    var = jnp.mean(jnp.square(xf - mu), axis=-1, keepdims=True)
    y = (xf - mu) * lax.rsqrt(var + LN_EPS) * g.astype(jnp.float32) + b.astype(jnp.float32)
    return y.astype(x.dtype)


def rms_norm(x, g):
    xf = x.astype(jnp.float32)
    y = xf * lax.rsqrt(jnp.mean(jnp.square(xf), axis=-1, keepdims=True) + LN_EPS)
    return (y * g.astype(jnp.float32)).astype(x.dtype)


def rope(x, positions):
    d = x.shape[-1]
    inv_freq = 1.0 / (ROPE_THETA ** (jnp.arange(0, d, 2, dtype=jnp.float32) / d))
    ang = positions.astype(jnp.float32)[..., None] * inv_freq
    ang = ang.reshape(ang.shape[:2] + (1,) * (x.ndim - 3) + ang.shape[-1:])
    cos, sin = jnp.cos(ang), jnp.sin(ang)
    xf = x.astype(jnp.float32)
    x1, x2 = xf[..., : d // 2], xf[..., d // 2:]
    return jnp.concatenate([x1 * cos - x2 * sin, x2 * cos + x1 * sin], axis=-1).astype(x.dtype)


def diff_attention(q, k, v, lam_vecs, lambda_init, subln_g):
    B, S, H, _, d = q.shape
    nb = S // Q_BLOCK
    lam = (jnp.exp(jnp.sum(lam_vecs[0].astype(jnp.float32) * lam_vecs[1].astype(jnp.float32)))
           - jnp.exp(jnp.sum(lam_vecs[2].astype(jnp.float32) * lam_vecs[3].astype(jnp.float32)))
           + lambda_init)
    q = q * (d ** -0.5)
    q_blocks = jnp.moveaxis(q.reshape(B, nb, Q_BLOCK, H, 2, d), 1, 0)
    q_chunk = (jnp.arange(S) // CHUNK).reshape(nb, Q_BLOCK)
    k_chunk = jnp.arange(S) // CHUNK

    def one_block(args):
        qb, qc = args
        s = jnp.einsum('bqhtd,bkhtd->bthqk', qb, k).astype(jnp.float32)
        allowed = k_chunk[None, :] <= qc[:, None]
        p = jax.nn.softmax(jnp.where(allowed, s, NEG_INF), axis=-1)
        a = p[:, 0] - lam * p[:, 1]
        return jnp.einsum('bhqk,bkhe->bqhe', a.astype(v.dtype), v)

    o = lax.map(one_block, (q_blocks, q_chunk))
    o = jnp.moveaxis(o, 0, 1).reshape(B, S, H, v.shape[-1])
    return rms_norm(o, subln_g) * (1.0 - lambda_init)


def band_chunks(t, nc):
    B, S, H, d = t.shape
    tc = t.reshape(B, nc, CHUNK, H, d)
    tp = jnp.pad(tc, ((0, 0), (LEFT_CHUNKS, 0), (0, 0), (0, 0), (0, 0)))
    return jnp.concatenate([tp[:, j:j + nc] for j in range(LEFT_CHUNKS + 1)], axis=2)


def chunk_rel_attention(q, k, v, rel_bias):
    B, S, H, d = q.shape
    nc = S // CHUNK
    qc = (q * (d ** -0.5)).reshape(B, nc, CHUNK, H, d)
    kband = band_chunks(k, nc)
    vband = band_chunks(v, nc)
    s = jnp.einsum('bnqhd,bnkhd->bnhqk', qc, kband).astype(jnp.float32)
    qi = np.arange(CHUNK)[:, None]
    kj = np.arange(BAND)[None, :]
    rel_idx = np.clip(qi + LEFT_CHUNKS * CHUNK - kj, -REL_CLIP, REL_CLIP) + REL_CLIP
    bias = rel_bias[:, rel_idx].astype(jnp.float32)
    key_pos = (jnp.arange(nc)[:, None] - LEFT_CHUNKS) * CHUNK + jnp.arange(BAND)[None, :]
    valid = key_pos >= 0
    s = jnp.where(valid[None, :, None, None, :], s + bias[None, None], NEG_INF)
    p = jax.nn.softmax(s, axis=-1)
    o = jnp.einsum('bnhqk,bnkhd->bnqhd', p.astype(v.dtype), vband)
    return o.reshape(B, S, H, d)


def hybrid_mixer(x, positions, w_in, lam_vecs, lambda_init, subln_g, rel_bias, w_o):
    B, S, _ = x.shape
    h = x @ w_in
    qa, ka, va, qb, kb, vb = jnp.split(h, np.cumsum(IN_SPLITS)[:-1], axis=-1)
    qa = rope(qa.reshape(B, S, N_HEADS_DIFF, 2, HEAD_DIM), positions)
    ka = rope(ka.reshape(B, S, N_HEADS_DIFF, 2, HEAD_DIM), positions)
    va = va.reshape(B, S, N_HEADS_DIFF, DIFF_V_DIM)
    ya = diff_attention(qa, ka, va, lam_vecs, lambda_init, subln_g)
    yb = chunk_rel_attention(qb.reshape(B, S, N_HEADS_CHUNK, HEAD_DIM),
                             kb.reshape(B, S, N_HEADS_CHUNK, HEAD_DIM),
                             vb.reshape(B, S, N_HEADS_CHUNK, HEAD_DIM), rel_bias)
    y = jnp.concatenate([ya.reshape(B, S, W_DIFF_V), yb.reshape(B, S, W_CHUNK)], axis=-1)
    return y @ w_o


def memory_cross_attention(x, mem, w_mq, w_mk, w_mv, w_mo):
    B, S, _ = x.shape
    M = mem.shape[1]
    q = (x @ w_mq).reshape(B, S, N_HEADS_MEM, MEM_HEAD_DIM) * (MEM_HEAD_DIM ** -0.5)
    k = (mem @ w_mk).reshape(B, M, N_HEADS_MEM, MEM_HEAD_DIM)
    v = (mem @ w_mv).reshape(B, M, N_HEADS_MEM, MEM_HEAD_DIM)
    s = jnp.einsum('bshd,bmhd->bhsm', q, k).astype(jnp.float32)
    p = jax.nn.softmax(s, axis=-1)
    o = jnp.einsum('bhsm,bmhd->bshd', p.astype(v.dtype), v).reshape(B, S, D_MODEL)
    return o @ w_mo


def sq_relu_mlp(x, w_up, w_down):
    return jnp.square(jax.nn.relu(x @ w_up)) @ w_down


def setup_inputs(seed: int = 0) -> dict:
    key = jax.random.key(seed)
    ks = jax.random.split(key, 24)
    f32 = jnp.float32
    beta = DEEPNORM_BETA
    x = jax.random.normal(ks[0], (BATCH, SEQ, D_MODEL), f32)
    mem = jax.random.normal(ks[1], (BATCH, N_MEM, D_MODEL), f32)
    start = jax.random.randint(ks[2], (BATCH, 1), 0, 64, dtype=jnp.int32) * CHUNK
    positions = (start + jnp.arange(SEQ, dtype=jnp.int32)[None, :]).astype(jnp.int32)
    col_scale = jnp.concatenate([
        jnp.ones((2 * W_DIFF_QK,), f32), jnp.full((W_DIFF_V,), beta, f32),
        jnp.ones((2 * W_CHUNK,), f32), jnp.full((W_CHUNK,), beta, f32)])
    w_in = jax.random.normal(ks[3], (DEPTH, D_MODEL, IN_WIDTH), f32) * (D_MODEL ** -0.5) * col_scale
    diff_lambda = jax.random.normal(ks[4], (DEPTH, 4, HEAD_DIM), f32) * 0.1
    subln_g = 1.0 + 0.02 * jax.random.normal(ks[5], (DEPTH, DIFF_V_DIM), f32)
    rel_bias = 0.2 * jax.random.normal(ks[6], (DEPTH, N_HEADS_CHUNK, 2 * REL_CLIP + 1), f32)
    w_o = jax.random.normal(ks[7], (DEPTH, MIX_WIDTH, D_MODEL), f32) * (MIX_WIDTH ** -0.5) * beta
    ln1_g = 1.0 + 0.02 * jax.random.normal(ks[8], (DEPTH, D_MODEL), f32)
    ln1_b = 0.02 * jax.random.normal(ks[9], (DEPTH, D_MODEL), f32)
    w_mq = jax.random.normal(ks[10], (DEPTH, D_MODEL, D_MODEL), f32) * (D_MODEL ** -0.5)
    w_mk = jax.random.normal(ks[11], (DEPTH, D_MODEL, D_MODEL), f32) * (D_MODEL ** -0.5)
    w_mv = jax.random.normal(ks[12], (DEPTH, D_MODEL, D_MODEL), f32) * (D_MODEL ** -0.5) * beta
    w_mo = jax.random.normal(ks[13], (DEPTH, D_MODEL, D_MODEL), f32) * (D_MODEL ** -0.5) * beta
    ln2_g = 1.0 + 0.02 * jax.random.normal(ks[14], (DEPTH, D_MODEL), f32)
    ln2_b = 0.02 * jax.random.normal(ks[15], (DEPTH, D_MODEL), f32)
    w_up = jax.random.normal(ks[16], (DEPTH, D_MODEL, D_FF), f32) * (D_MODEL ** -0.5) * beta
    w_down = jax.random.normal(ks[17], (DEPTH, D_FF, D_MODEL), f32) * (D_FF ** -0.5) * beta
    ln3_g = 1.0 + 0.02 * jax.random.normal(ks[18], (DEPTH, D_MODEL), f32)
    ln3_b = 0.02 * jax.random.normal(ks[19], (DEPTH, D_MODEL), f32)
    return {"x": x, "mem": mem, "positions": positions, "w_in": w_in,
            "diff_lambda": diff_lambda, "subln_g": subln_g, "rel_bias": rel_bias,
            "w_o": w_o, "ln1_g": ln1_g, "ln1_b": ln1_b,
            "w_mq": w_mq, "w_mk": w_mk, "w_mv": w_mv, "w_mo": w_mo,
            "ln2_g": ln2_g, "ln2_b": ln2_b, "w_up": w_up, "w_down": w_down,
            "ln3_g": ln3_g, "ln3_b": ln3_b}


def reference(x, mem, positions, w_in, diff_lambda, subln_g, rel_bias, w_o, ln1_g, ln1_b,
              w_mq, w_mk, w_mv, w_mo, ln2_g, ln2_b, w_up, w_down, ln3_g, ln3_b):
    alpha = DEEPNORM_ALPHA
    for l in range(DEPTH):
        lambda_init = 0.8 - 0.6 * math.exp(-0.3 * l)
        y = hybrid_mixer(x, positions, w_in[l], diff_lambda[l], lambda_init, subln_g[l],
                         rel_bias[l], w_o[l])
        x = layer_norm(alpha * x + y, ln1_g[l], ln1_b[l])
        y = memory_cross_attention(x, mem, w_mq[l], w_mk[l], w_mv[l], w_mo[l])
        x = layer_norm(alpha * x + y, ln2_g[l], ln2_b[l])
        y = sq_relu_mlp(x, w_up[l], w_down[l])
        x = layer_norm(alpha * x + y, ln3_g[l], ln3_b[l])
    return x
```

```cpp
#include <hip/hip_runtime.h>
#include <hip/hip_bf16.h>
#include <cstdio>
#include <cstdint>
#include <cmath>

#define LAS __attribute__((address_space(3)))
#define GAS __attribute__((address_space(1)))

constexpr int BATCH = 8, SEQ = 2048, DM = 1024, MTOK = BATCH * SEQ;
constexpr int NMEM = 256, MMEM = BATCH * NMEM;
constexpr int INW = 3072, DFF = 4096;
constexpr float LN_EPS = 1e-5f;
constexpr float ALPHA = 1.189207115002721f;
constexpr float LOG2E = 1.4426950408889634f;
constexpr float C2_64 = 0.125f * LOG2E;
constexpr float C2_256 = 0.0625f * LOG2E;
constexpr float LAMBDA_INIT = 0.2f;

namespace pg8 {
#define PG8_LAS __attribute__((address_space(3)))
typedef unsigned short bf16_t;
typedef short bf16x8 __attribute__((ext_vector_type(8)));
typedef float f32x4 __attribute__((ext_vector_type(4)));
typedef float f32x2 __attribute__((ext_vector_type(2)));
typedef unsigned u32x4 __attribute__((ext_vector_type(4)));
typedef unsigned u32x2 __attribute__((ext_vector_type(2)));
constexpr int BM = 256, BK = 64, HALF = 128, HTB = HALF * BK * 2  , STAGE_BYTES = 8 * HTB, NXCD = 8, WGM = 8;

__host__ __device__ __forceinline__ int lds_byte(int r, int c) { const int st = (r >> 4) * 2 + (c >> 5), rr = r & 15, cc = c & 31, ob = rr * 64 + cc * 2; return st * 1024 + (ob ^ (((ob >> 9) & 1) << 5)); }
__host__ __device__ __forceinline__ void stage_rc(int b, int& R, int& C) { const int st = b / 1024, sb = b % 1024, swz = sb ^ (((sb >> 9) & 1) << 5); R = (st >> 1) * 16 + swz / 64; C = (st & 1) * 32 + (swz % 64) / 2; }
__host__ __device__ __forceinline__ int perm32(int rho) { const int n = rho >> 4, i = rho & 15; return 8 * (i >> 2) + 4 * n + (i & 3); }

struct Unit { int pm, pn; size_t ao, bo; };
struct Gemm { const bf16_t* A; const bf16_t* Bt; int lda, ldb, K; };

struct StaticOrder {
    int nM, nN, nwg, G, c, lda, ldb, c0;
    __host__ __device__ void init(int M, int N, int lda_, int ldb_, int G_, int c_, int c0_ = 0) { nM = M / BM; nN = N / BM; nwg = nM * nN; G = G_; c = c_; lda = lda_; ldb = ldb_; c0 = c0_; }
    __host__ __device__ bool next(int i, Unit& u) const {
        if (c < c0) return false;
        const long L = (long)i * G + (c - c0); if (L >= nwg) return false;
        int wgid = (int)L; { const int q = nwg / NXCD, r = nwg % NXCD, xcd = wgid % NXCD, off = wgid / NXCD; wgid = (xcd < r ? xcd * (q + 1) : r * (q + 1) + (xcd - r) * q) + off; }
        const int nig = WGM * nN, gid = wgid / nig, fm = gid * WGM, gsz = (nM - fm) < WGM ? (nM - fm) : WGM;
        u.pm = fm + ((wgid % nig) % gsz); u.pn = (wgid % nig) / gsz;
        u.ao = (size_t)u.pm * BM * lda * 2; u.bo = (size_t)u.pn * BM * ldb * 2; return true;
    }
    __device__ __forceinline__ void a_ready(const Unit&) const {}
    __device__ __forceinline__ void done(const Unit&) const {}
};

__device__ __forceinline__ unsigned cvt_pk_bf16(float lo, float hi) { unsigned r; asm volatile("v_cvt_pk_bf16_f32 %0, %1, %2" : "=v"(r) : "v"(lo), "v"(hi)); return r; }


template <int ACT> struct EpiBf16 {
    static constexpr bool PERM = true, AFTER_DRAIN = false;
    bf16_t* O; int ldc; float scale;
    __device__ __forceinline__ void operator()(const f32x4 (&acc)[2][2][4][2], const Unit& u, int wr, int wc, int fr, int fq) const {
        const int row0 = u.pm * BM + wr * 64 + fr; const int col0 = u.pn * BM + wc * 32 + 8 * fq;
#pragma unroll
        for (int ai = 0; ai < 2; ++ai)
#pragma unroll
            for (int m = 0; m < 4; ++m) { bf16_t* rowp = O + (size_t)(row0 + ai * HALF + m * 16) * ldc + col0;
#pragma unroll
                for (int bj = 0; bj < 2; ++bj) { f32x4 v0 = acc[ai][bj][m][0], v1 = acc[ai][bj][m][1];
                    if (ACT == 2) {
#pragma unroll
                        for (int e = 0; e < 4; ++e) { const float a = fmaxf(v0[e], 0.f), b = fmaxf(v1[e], 0.f); v0[e] = a * a; v1[e] = b * b; } }
                    v0 = v0 * scale; v1 = v1 * scale; u32x4 w; w.x = cvt_pk_bf16(v0[0], v0[1]); w.y = cvt_pk_bf16(v0[2], v0[3]); w.z = cvt_pk_bf16(v1[0], v1[1]); w.w = cvt_pk_bf16(v1[2], v1[3]);
                    *(u32x4*)(rowp + bj * HALF) = w; } }
    }
};

struct EpiInProj {
    static constexpr bool PERM = true, AFTER_DRAIN = false;
    bf16_t* H; const float* cosT; const float* sinT;
    __device__ __forceinline__ void operator()(const f32x4 (&acc)[2][2][4][2], const Unit& u, int wr, int wc, int fr, int fq) const {
        const int row0 = u.pm * BM + wr * 64 + fr; const int col0 = u.pn * BM + wc * 32 + 8 * fq;
        const bool rope = u.pn < 4; const float sc = (u.pn < 2 || u.pn == 6 || u.pn == 7) ? C2_64 : 1.f;
        const int g4 = 4 * (4 * (wc & 1) + fq);
#pragma unroll
        for (int ai = 0; ai < 2; ++ai)
#pragma unroll
            for (int m = 0; m < 4; ++m) { const int row = row0 + ai * HALF + m * 16; bf16_t* rowp = H + (size_t)row * INW + col0;
                f32x4 cs = (f32x4){1.f, 1.f, 1.f, 1.f}, sn = (f32x4){0.f, 0.f, 0.f, 0.f};
                if (rope) { cs = *(const f32x4*)(cosT + (size_t)row * 32 + g4); sn = *(const f32x4*)(sinT + (size_t)row * 32 + g4); }
#pragma unroll
                for (int bj = 0; bj < 2; ++bj) { const f32x4 x1 = acc[ai][bj][m][0], x2 = acc[ai][bj][m][1];
                    f32x4 v0 = (x1 * cs - x2 * sn) * sc, v1 = (x2 * cs + x1 * sn) * sc;
                    u32x4 w; w.x = cvt_pk_bf16(v0[0], v0[1]); w.y = cvt_pk_bf16(v0[2], v0[3]); w.z = cvt_pk_bf16(v1[0], v1[1]); w.w = cvt_pk_bf16(v1[2], v1[3]);
                    *(u32x4*)(rowp + bj * HALF) = w; } }
    }
};

struct EpiResF32 {
    static constexpr bool PERM = false, AFTER_DRAIN = false;
    const float* base; float* out; int ldc; float alpha;
    __device__ __forceinline__ void operator()(const f32x4 (&acc)[2][2][4][2], const Unit& u, int wr, int wc, int fr, int fq) const {
        const int col0 = u.pn * BM + wc * 32 + 4 * fq;
#pragma unroll
        for (int ai = 0; ai < 2; ++ai)
#pragma unroll
            for (int m = 0; m < 4; ++m) { const size_t off = (size_t)(u.pm * BM + ai * HALF + wr * 64 + m * 16 + fr) * ldc + col0;
#pragma unroll
                for (int bj = 0; bj < 2; ++bj)
#pragma unroll
                    for (int n = 0; n < 2; ++n) { const f32x4 bs = *(const f32x4*)(base + off + bj * HALF + n * 16); *(f32x4*)(out + off + bj * HALF + n * 16) = bs * alpha + acc[ai][bj][m][n]; } }
    }
};

struct EpiSoftmaxP {
    static constexpr bool PERM = true, AFTER_DRAIN = true;
    bf16_t* P; int ldc;
    __device__ __forceinline__ void fused(f32x4 (&acc)[2][2][4][2], const Unit& u, int wr, int wc, int fr, int fq, PG8_LAS unsigned char* lds, int wid, int lane) const {
        PG8_LAS float* Pm = (PG8_LAS float*)lds;
        PG8_LAS float* Ps = (PG8_LAS float*)(lds + 4096);
#pragma unroll
        for (int ai = 0; ai < 2; ++ai)
#pragma unroll
            for (int m = 0; m < 4; ++m) { float mx = -INFINITY;
#pragma unroll
                for (int bj = 0; bj < 2; ++bj)
#pragma unroll
                    for (int n = 0; n < 2; ++n) { const f32x4 x = acc[ai][bj][m][n]; mx = fmaxf(mx, fmaxf(fmaxf(x[0], x[1]), fmaxf(x[2], x[3]))); }
                mx = fmaxf(mx, __shfl_xor(mx, 16)); mx = fmaxf(mx, __shfl_xor(mx, 32));
                if (fq == 0) Pm[(ai * HALF + wr * 64 + m * 16 + fr) * 4 + wc] = mx; }
        asm volatile("s_waitcnt lgkmcnt(0)" ::: "memory"); __builtin_amdgcn_s_barrier(); asm volatile("" ::: "memory");
#pragma unroll
        for (int ai = 0; ai < 2; ++ai)
#pragma unroll
            for (int m = 0; m < 4; ++m) { const int r = ai * HALF + wr * 64 + m * 16 + fr; const f32x4 q = *(const PG8_LAS f32x4*)(Pm + r * 4);
                const float mx = fmaxf(fmaxf(q[0], q[1]), fmaxf(q[2], q[3])); float s = 0.f;
#pragma unroll
                for (int bj = 0; bj < 2; ++bj)
#pragma unroll
                    for (int n = 0; n < 2; ++n) { f32x4 x = acc[ai][bj][m][n];
#pragma unroll
                        for (int e = 0; e < 4; ++e) { x[e] = __builtin_amdgcn_exp2f(x[e] - mx); s += x[e]; }
                        acc[ai][bj][m][n] = x; }
                s += __shfl_xor(s, 16); s += __shfl_xor(s, 32);
                if (fq == 0) Ps[r * 4 + wc] = s; }
        asm volatile("s_waitcnt lgkmcnt(0)" ::: "memory"); __builtin_amdgcn_s_barrier(); asm volatile("" ::: "memory");
        const int row0 = u.pm * BM + wr * 64 + fr; const int col0 = u.pn * BM + wc * 32 + 8 * fq;
#pragma unroll
        for (int ai = 0; ai < 2; ++ai)
#pragma unroll
            for (int m = 0; m < 4; ++m) { const int r = ai * HALF + wr * 64 + m * 16 + fr; const f32x4 q = *(const PG8_LAS f32x4*)(Ps + r * 4);
                const float inv = 1.0f / ((q[0] + q[1]) + (q[2] + q[3])); bf16_t* rowp = P + (size_t)(row0 + ai * HALF + m * 16) * ldc + col0;
#pragma unroll
                for (int bj = 0; bj < 2; ++bj) { const f32x4 v0 = acc[ai][bj][m][0] * inv, v1 = acc[ai][bj][m][1] * inv;
                    u32x4 w; w.x = cvt_pk_bf16(v0[0], v0[1]); w.y = cvt_pk_bf16(v0[2], v0[3]); w.z = cvt_pk_bf16(v1[0], v1[1]); w.w = cvt_pk_bf16(v1[2], v1[3]);
                    *(u32x4*)(rowp + bj * HALF) = w; } }
        asm volatile("s_waitcnt lgkmcnt(0)" ::: "memory"); __builtin_amdgcn_s_barrier(); asm volatile("" ::: "memory");
    }
};

template <class Epi, class Sched, bool ALIGN_EPI = false, bool SP2 = false>
__device__ __forceinline__ void gemm_phase(PG8_LAS unsigned char* lds, const Gemm g, const Sched& S, const Epi& E) {
    const int tid = threadIdx.x, wid = __builtin_amdgcn_readfirstlane(tid >> 6), lane = tid & 63, wr = wid >> 2, wc = wid & 3, fr = lane & 15, fq = lane >> 4;
    const int K = g.K, nt = K / BK;
    unsigned voffA[2], voffB[2];
#pragma unroll
    for (int i = 0; i < 2; ++i) { int R, C; stage_rc(tid * 16 + i * 8192, R, C); const int Rb = Epi::PERM ? ((R & ~31) + perm32(R & 31)) : R;
        voffA[i] = (unsigned)(R * g.lda + C) * 2u; voffB[i] = (unsigned)(Rb * g.ldb + C) * 2u; }
    const size_t kstep = (size_t)(BK * 2);
    const size_t hstepA = (size_t)HALF * g.lda * 2, hstepB = (size_t)HALF * g.ldb * 2;
    const unsigned ldsw = (unsigned)wid * 1024u;
    const int aoff = lds_byte(wr * 64 + fr, fq * 8), boff = lds_byte(wc * 32 + fr, fq * 8);
#define PG8_SA(b, h) (((b) * 2 + (h)) * HTB)
#define PG8_SB(b, h) ((4 + (b) * 2 + (h)) * HTB)
#define PG8_STAGE(bufoff, gbase, voff) do { _Pragma("unroll") for (int _i = 0; _i < 2; ++_i) \
        __builtin_amdgcn_global_load_lds((const unsigned*)((const char*)(gbase) + (voff)[_i]), (PG8_LAS unsigned*)(lds + (bufoff) + ldsw + _i * 8192), 16, 0, 0); } while (0)
#define PG8_LDA(dst, b, h) do { _Pragma("unroll") for (int m = 0; m < 4; ++m) _Pragma("unroll") for (int k = 0; k < 2; ++k) dst[m][k] = *(const PG8_LAS bf16x8*)(lds + PG8_SA(b, h) + aoff + m * 2048 + k * 1024); } while (0)
#define PG8_LDB(dst, b, h) do { _Pragma("unroll") for (int n = 0; n < 2; ++n) _Pragma("unroll") for (int k = 0; k < 2; ++k) dst[n][k] = *(const PG8_LAS bf16x8*)(lds + PG8_SB(b, h) + boff + n * 2048 + k * 1024); } while (0)
#define PG8_MMA(ai, bj, At, Bt) do { __builtin_amdgcn_s_setprio(1); _Pragma("unroll") for (int m = 0; m < 4; ++m) _Pragma("unroll") for (int n = 0; n < 2; ++n) _Pragma("unroll") for (int k = 0; k < 2; ++k) \
        acc[ai][bj][m][n] = __builtin_amdgcn_mfma_f32_16x16x32_bf16(Bt[n][k], At[m][k], acc[ai][bj][m][n], 0, 0, 0); __builtin_amdgcn_s_setprio(0); } while (0)
#define PG8_WAIT_V(n) asm volatile("s_waitcnt vmcnt(" #n ")" ::: "memory")
#define PG8_WAIT_L(n) asm volatile("s_waitcnt lgkmcnt(" #n ")" ::: "memory")
#define PG8_BAR __builtin_amdgcn_s_barrier()
#define PG8_SCHED __builtin_amdgcn_sched_barrier(0)
    Unit cur, nxt; int ui = 0;
    if (!S.next(0, cur)) return;
    f32x4 acc[2][2][4][2];
#pragma unroll
    for (int a = 0; a < 2; ++a)
#pragma unroll
        for (int b = 0; b < 2; ++b)
#pragma unroll
            for (int m = 0; m < 4; ++m)
#pragma unroll
                for (int n = 0; n < 2; ++n) acc[a][b][m][n] = (f32x4){0.f, 0.f, 0.f, 0.f};
    bf16x8 At[4][2], B0[2][2], B1[2][2];
    const char* cA = (const char*)g.A + cur.ao; const char* cB = (const char*)g.Bt + cur.bo;
    S.a_ready(cur);
    if constexpr (SP2) {
        PG8_STAGE(PG8_SB(0, 0), cB, voffB); PG8_STAGE(PG8_SB(0, 1), cB + hstepB, voffB); PG8_STAGE(PG8_SA(0, 0), cA, voffA); PG8_STAGE(PG8_SA(0, 1), cA + hstepA, voffA);
        if (wr == 1) PG8_BAR;
        PG8_WAIT_V(2); PG8_BAR;
        PG8_STAGE(PG8_SB(1, 0), cB + kstep, voffB); PG8_STAGE(PG8_SA(1, 0), cA + kstep, voffA); PG8_STAGE(PG8_SB(1, 1), cB + hstepB + kstep, voffB);
        PG8_WAIT_V(6); PG8_BAR;
    } else {
        PG8_STAGE(PG8_SB(0, 0), cB, voffB); PG8_STAGE(PG8_SA(0, 0), cA, voffA); PG8_STAGE(PG8_SB(0, 1), cB + hstepB, voffB); PG8_STAGE(PG8_SA(0, 1), cA + hstepA, voffA);
        if (wr == 1) PG8_BAR;
        PG8_WAIT_V(4); PG8_BAR;
        PG8_STAGE(PG8_SB(1, 0), cB + kstep, voffB); PG8_STAGE(PG8_SA(1, 0), cA + kstep, voffA); PG8_STAGE(PG8_SB(1, 1), cB + hstepB + kstep, voffB);
        PG8_WAIT_V(6); PG8_BAR;
    }
    for (;;) {
        const bool has_next = S.next(ui + 1, nxt);
        const char* nA = has_next ? (const char*)g.A + nxt.ao : cA; const char* nB = has_next ? (const char*)g.Bt + nxt.bo : cB;
        for (int t = 0; t < nt; t += 2) {
            const bool last = (t == nt - 2);
            const char* a1 = cA + (size_t)(t + 1) * kstep;
            const char* a2 = last ? nA : cA + (size_t)(t + 2) * kstep; const char* b2 = last ? nB : cB + (size_t)(t + 2) * kstep;
            const char* a3 = a2 + kstep; const char* b3 = b2 + kstep;
            if (last && has_next) S.a_ready(nxt);
            if constexpr (SP2) {
            PG8_LDB(B0, 0, 0); PG8_LDB(B1, 0, 1); PG8_SCHED; PG8_LDA(At, 0, 0); PG8_STAGE(PG8_SA(1, 1), a1 + hstepA, voffA);
            PG8_WAIT_V(8); PG8_WAIT_L(0); PG8_BAR; PG8_MMA(0, 0, At, B0); PG8_MMA(0, 1, At, B1); PG8_BAR; PG8_SCHED;
            PG8_LDA(At, 0, 1); PG8_STAGE(PG8_SB(0, 0), b2, voffB); PG8_STAGE(PG8_SB(0, 1), b2 + hstepB, voffB); PG8_STAGE(PG8_SA(0, 0), a2, voffA);
            PG8_WAIT_V(8); PG8_WAIT_L(0); PG8_BAR; PG8_MMA(1, 0, At, B0); PG8_MMA(1, 1, At, B1); PG8_BAR; PG8_SCHED;
            PG8_LDB(B0, 1, 0); PG8_LDB(B1, 1, 1); PG8_SCHED; PG8_LDA(At, 1, 0); PG8_STAGE(PG8_SA(0, 1), a2 + hstepA, voffA);
            PG8_WAIT_V(8); PG8_WAIT_L(0); PG8_BAR; PG8_MMA(0, 0, At, B0); PG8_MMA(0, 1, At, B1); PG8_BAR; PG8_SCHED;
            PG8_LDA(At, 1, 1); PG8_STAGE(PG8_SB(1, 0), b3, voffB); PG8_STAGE(PG8_SB(1, 1), b3 + hstepB, voffB); PG8_STAGE(PG8_SA(1, 0), a3, voffA);
            PG8_WAIT_V(8); PG8_WAIT_L(0); PG8_BAR; PG8_MMA(1, 0, At, B0); PG8_MMA(1, 1, At, B1); PG8_BAR; PG8_SCHED;
            } else {
            PG8_LDB(B0, 0, 0); PG8_SCHED; PG8_LDA(At, 0, 0); PG8_STAGE(PG8_SA(1, 1), a1 + hstepA, voffA);
            PG8_WAIT_L(8); PG8_BAR; PG8_WAIT_L(0); PG8_MMA(0, 0, At, B0); PG8_BAR; PG8_SCHED;
            PG8_LDB(B1, 0, 1); PG8_STAGE(PG8_SB(0, 0), b2, voffB);
            PG8_BAR; PG8_WAIT_L(0); PG8_MMA(0, 1, At, B1); PG8_BAR;
            PG8_LDA(At, 0, 1); PG8_STAGE(PG8_SA(0, 0), a2, voffA);
            PG8_BAR; PG8_WAIT_L(0); PG8_MMA(1, 0, At, B0); PG8_BAR; PG8_SCHED;
            PG8_STAGE(PG8_SB(0, 1), b2 + hstepB, voffB);
            PG8_WAIT_V(6); PG8_BAR; PG8_MMA(1, 1, At, B1); PG8_BAR;
            PG8_LDB(B0, 1, 0); PG8_SCHED; PG8_LDA(At, 1, 0); PG8_STAGE(PG8_SA(0, 1), a2 + hstepA, voffA);
            PG8_WAIT_L(8); PG8_BAR; PG8_WAIT_L(0); PG8_MMA(0, 0, At, B0); PG8_BAR; PG8_SCHED;
            PG8_LDB(B1, 1, 1); PG8_STAGE(PG8_SB(1, 0), b3, voffB);
            PG8_BAR; PG8_WAIT_L(0); PG8_MMA(0, 1, At, B1); PG8_BAR;
            PG8_LDA(At, 1, 1); PG8_STAGE(PG8_SA(1, 0), a3, voffA);
            PG8_BAR; PG8_WAIT_L(0); PG8_MMA(1, 0, At, B0); PG8_BAR; PG8_SCHED;
            PG8_STAGE(PG8_SB(1, 1), b3 + hstepB, voffB);
            PG8_WAIT_V(6); PG8_BAR; PG8_MMA(1, 1, At, B1); PG8_BAR;
            }
        }
        if constexpr (ALIGN_EPI) { if (wr == 0) PG8_BAR; }
        if constexpr (!Epi::AFTER_DRAIN) { E(acc, cur, wr, wc, fr, fq); S.done(cur); }
        if (!has_next) break;
#pragma unroll
        for (int a = 0; a < 2; ++a)
#pragma unroll
            for (int b = 0; b < 2; ++b)
#pragma unroll
                for (int m = 0; m < 4; ++m)
#pragma unroll
                    for (int n = 0; n < 2; ++n) acc[a][b][m][n] = (f32x4){0.f, 0.f, 0.f, 0.f};
        cur = nxt; cA = nA; cB = nB; ++ui;
        if constexpr (ALIGN_EPI) { if (wr == 1) PG8_BAR; }
    }
    PG8_WAIT_V(0);
    if constexpr (!ALIGN_EPI) { if (wr == 0) PG8_BAR; }
    PG8_BAR;
    if constexpr (Epi::AFTER_DRAIN) { E.fused(acc, cur, wr, wc, fr, fq, lds, wid, lane); S.done(cur); }
#undef PG8_SA
#undef PG8_SB
#undef PG8_STAGE
#undef PG8_LDA
#undef PG8_LDB
#undef PG8_MMA
#undef PG8_WAIT_V
#undef PG8_WAIT_L
#undef PG8_BAR
#undef PG8_SCHED
}
}

namespace att {
using pg8::bf16_t; using pg8::bf16x8; using pg8::u32x4;
typedef short s16x4 __attribute__((ext_vector_type(4)));
typedef float f32x16 __attribute__((ext_vector_type(16)));
typedef LAS const char* lds_cptr;
typedef short v4i16_t __attribute__((ext_vector_type(4)));
typedef float f32x2_t __attribute__((ext_vector_type(2))); typedef __bf16 bf16x2_t __attribute__((ext_vector_type(2)));
__device__ __forceinline__ int crow(int r, int hi) { return (r & 3) + 8 * (r >> 2) + 4 * hi; }
__device__ __forceinline__ unsigned cvtpk(float lo, float hi) { f32x2_t v = {lo, hi}; bf16x2_t b = __builtin_convertvector(v, bf16x2_t); return __builtin_bit_cast(unsigned, b); }
__device__ __forceinline__ s16x4 vtr(lds_cptr p) { return __builtin_bit_cast(s16x4, __builtin_amdgcn_ds_read_tr16_b64_v4i16((LAS v4i16_t*)p)); }
__device__ __forceinline__ unsigned short f2bf(float f) { return (unsigned short)(cvtpk(f, 0.f) & 0xffffu); }
#define ATT_MFMA(a, b, c) __builtin_amdgcn_mfma_f32_32x32x16_bf16(a, b, c, 0, 0, 0)

template <int NSUB, int NVB>
__device__ __forceinline__ void stage_tile(LAS unsigned char* buf, const bf16_t* Kt, const bf16_t* Vt, int wid, int lane) {
    constexpr int NKP = NSUB * 8, NP = NKP + NVB * 4;
#pragma unroll
    for (int p0 = 0; p0 < NP; p0 += 8) { const int p = p0 + wid; const bf16_t* src;
        if (p0 < NKP) src = Kt + (size_t)lane * INW + (p >> 3) * 64 + (p & 7) * 8;
        else { const int pv = p - NKP; src = Vt + (size_t)(16 * (pv & 3) + (lane >> 2)) * INW + (pv >> 2) * 32 + (lane & 3) * 8; }
        __builtin_amdgcn_global_load_lds((const unsigned*)src, (LAS unsigned*)(buf + p * 1024), 16, 0, 0); }
}
__device__ __forceinline__ void qk_tile(f32x16& p0, f32x16& p1, lds_cptr kp, const bf16x8 (&qr)[4]) {
    const f32x16 z = f32x16{};
#pragma unroll
    for (int d0 = 0; d0 < 4; ++d0) { const bf16x8 b0 = *(const LAS bf16x8*)(kp + d0 * 2048), b1 = *(const LAS bf16x8*)(kp + d0 * 2048 + 512);
        if (d0 == 0) { p0 = ATT_MFMA(b0, qr[0], z); p1 = ATT_MFMA(b1, qr[0], z); } else { p0 = ATT_MFMA(b0, qr[d0], p0); p1 = ATT_MFMA(b1, qr[d0], p1); } }
}
template <int NDB, int THR>
__device__ __forceinline__ void softmax_pv(f32x16& p0, f32x16& p1, f32x16 (&o)[NDB], float& m, float& l, lds_cptr vp, LAS float* wsf, int r32, int hi) {
    float rm = fmaxf(p0[0], p1[0]);
#pragma unroll
    for (int r = 1; r < 16; ++r) rm = fmaxf(rm, fmaxf(p0[r], p1[r]));
    rm = fmaxf(rm, __shfl_xor(rm, 32));
    if (__any(rm > m + (float)THR)) {
        const float mn = fmaxf(m, rm), al = __builtin_amdgcn_exp2f(m - mn); m = mn; l *= al;
        if (hi == 0) wsf[r32] = al;
        asm volatile("s_waitcnt lgkmcnt(0)" ::: "memory");
#pragma unroll
        for (int r = 0; r < 16; ++r) { const float a = wsf[crow(r, hi)];
#pragma unroll
            for (int db = 0; db < NDB; ++db) o[db][r] *= a; }
        asm volatile("s_waitcnt lgkmcnt(0)" ::: "memory");
    }
    float rs = 0.f;
#pragma unroll
    for (int r = 0; r < 16; ++r) { p0[r] = __builtin_amdgcn_exp2f(p0[r] - m); p1[r] = __builtin_amdgcn_exp2f(p1[r] - m); rs += p0[r] + p1[r]; }
    l += rs;
    u32x4 pw[4];
#pragma unroll
    for (int e = 0; e < 4; ++e) { pw[0][e] = cvtpk(p0[2 * e], p0[2 * e + 1]); pw[1][e] = cvtpk(p0[8 + 2 * e], p0[9 + 2 * e]); pw[2][e] = cvtpk(p1[2 * e], p1[2 * e + 1]); pw[3][e] = cvtpk(p1[8 + 2 * e], p1[9 + 2 * e]); }
#pragma unroll
    for (int db = 0; db < NDB; ++db)
#pragma unroll
        for (int ks = 0; ks < 4; ++ks) { const s16x4 lo = vtr(vp + db * 4096 + ks * 1024), hh = vtr(vp + db * 4096 + ks * 1024 + 512);
            const bf16x8 vf = (bf16x8){lo[0], lo[1], lo[2], lo[3], hh[0], hh[1], hh[2], hh[3]};
            o[db] = ATT_MFMA(__builtin_bit_cast(bf16x8, pw[ks]), vf, o[db]); }
}

constexpr int THR_L2 = 8;
constexpr int A_BUF = 2 * 8192 + 4 * 4096;
constexpr int B_BUF = 4 * 8192 + 8 * 4096;
constexpr int WSF_OFF = 131072, BIAS_OFF = 131072 + 2048;

__device__ __forceinline__ void attnA_unit(int b, int hh, int j, const bf16_t* H, bf16_t* Y, const float* dlam, const float* subg, LAS unsigned char* lds) {
    const int tid = threadIdx.x, lane = tid & 63, r32 = lane & 31, hi = lane >> 5; const int wid = __builtin_amdgcn_readfirstlane(tid >> 6);
    const int rg = wid >> 1, t = wid & 1; const int q0 = j * 128 + rg * 32, qc = q0 >> 6, NT = 2 * j + 2;
    const size_t rowb = (size_t)b * SEQ;
    const bf16_t* Qw = H + (rowb + q0 + r32) * INW + hh * 128 + t * 64;
    bf16x8 qr[4];
#pragma unroll
    for (int d0 = 0; d0 < 4; ++d0) qr[d0] = *(const bf16x8*)(Qw + d0 * 16 + hi * 8);
    const bf16_t* Kg = H + rowb * INW + 512 + hh * 128; const bf16_t* Vg = H + rowb * INW + 1024 + hh * 128;
    LAS float* wsf = (LAS float*)(lds + WSF_OFF) + wid * 64;
    f32x16 o[4]; o[0] = f32x16{}; o[1] = f32x16{}; o[2] = f32x16{}; o[3] = f32x16{};
    float m = -INFINITY, l = 0.f;
    stage_tile<2, 4>(lds, Kg, Vg, wid, lane);
    for (int kt = 0; kt < NT; ++kt) {
        asm volatile("s_waitcnt vmcnt(0)" ::: "memory"); __syncthreads();
        LAS unsigned char* cur = lds + (kt & 1) * A_BUF;
        if (kt + 1 < NT) stage_tile<2, 4>(lds + ((kt + 1) & 1) * A_BUF, Kg + (size_t)(kt + 1) * 64 * INW, Vg + (size_t)(kt + 1) * 64 * INW, wid, lane);
        if (kt <= qc) {
            f32x16 p0, p1;
            qk_tile(p0, p1, (lds_cptr)cur + t * 8192 + hi * 1024 + r32 * 16, qr);
            softmax_pv<4, THR_L2>(p0, p1, o, m, l, (lds_cptr)cur + 2 * 8192 + ((lane >> 4) & 1) * 32 + (lane & 3) * 8 + (4 * hi + ((lane & 15) >> 2)) * 64, wsf, r32, hi);
        }
    }
    l += __shfl_xor(l, 32);
    if (hi == 0) wsf[r32] = 1.0f / l;
    asm volatile("s_waitcnt lgkmcnt(0)" ::: "memory");
    float inv[16];
#pragma unroll
    for (int r = 0; r < 16; ++r) inv[r] = wsf[crow(r, hi)];
    asm volatile("s_waitcnt lgkmcnt(0)" ::: "memory");
    __syncthreads();
    LAS float* XO = (LAS float*)lds + rg * 4096;
    if (t == 1) {
#pragma unroll
        for (int r = 0; r < 16; ++r)
#pragma unroll
            for (int db = 0; db < 4; ++db) XO[crow(r, hi) * 128 + db * 32 + r32] = o[db][r] * inv[r];
    }
    asm volatile("s_waitcnt lgkmcnt(0)" ::: "memory"); __syncthreads();
    if (t == 0) {
        float a1 = dlam[lane] * dlam[64 + lane], a2 = dlam[128 + lane] * dlam[192 + lane];
#pragma unroll
        for (int s = 1; s < 64; s <<= 1) { a1 += __shfl_xor(a1, s); a2 += __shfl_xor(a2, s); }
        const float lam = __expf(a1) - __expf(a2) + LAMBDA_INIT;
        float g[4];
#pragma unroll
        for (int db = 0; db < 4; ++db) g[db] = subg[db * 32 + r32] * (1.0f - LAMBDA_INIT);
        bf16_t* Yw = Y + (rowb + q0) * DM + hh * 128 + r32;
#pragma unroll
        for (int r = 0; r < 16; ++r) { float v[4]; float ss = 0.f;
#pragma unroll
            for (int db = 0; db < 4; ++db) { v[db] = o[db][r] * inv[r] - lam * XO[crow(r, hi) * 128 + db * 32 + r32]; ss += v[db] * v[db]; }
#pragma unroll
            for (int s = 1; s < 32; s <<= 1) ss += __shfl_xor(ss, s);
            const float rs = 1.0f / sqrtf(ss * (1.0f / 128.0f) + LN_EPS);
#pragma unroll
            for (int db = 0; db < 4; ++db) Yw[(size_t)crow(r, hi) * DM + db * 32] = f2bf(v[db] * rs * g[db]); }
    }
    asm volatile("s_waitcnt lgkmcnt(0)" ::: "memory"); __syncthreads();
}

__device__ __forceinline__ void attnB_unit(int b, int hg, int c, const bf16_t* H, bf16_t* Y, const float* relb, LAS unsigned char* lds) {
    const int tid = threadIdx.x, lane = tid & 63, r32 = lane & 31, hi = lane >> 5; const int wid = __builtin_amdgcn_readfirstlane(tid >> 6);
    const int hl = wid >> 1, half = wid & 1, h = hg * 4 + hl; const int q0 = c * 64 + half * 32;
    const size_t rowb = (size_t)b * SEQ;
    const bf16_t* Qw = H + (rowb + q0 + r32) * INW + 1536 + h * 64;
    bf16x8 qr[4];
#pragma unroll
    for (int d0 = 0; d0 < 4; ++d0) qr[d0] = *(const bf16x8*)(Qw + d0 * 16 + hi * 8);
    const bf16_t* Kg = H + rowb * INW + 2048 + hg * 256; const bf16_t* Vg = H + rowb * INW + 2560 + hg * 256;
    LAS float* wsf = (LAS float*)(lds + WSF_OFF) + wid * 64;
    LAS float* bias = (LAS float*)(lds + BIAS_OFF);
    for (int i = tid; i < 4 * 257; i += 512) { const int hq = i / 257, k = i - hq * 257; bias[hq * 260 + k] = relb[(hg * 4 + hq) * 257 + k] * LOG2E; }
    f32x16 o[2]; o[0] = f32x16{}; o[1] = f32x16{};
    float m = -INFINITY, l = 0.f;
    const int kc0 = c > 8 ? c - 8 : 0, NT = c - kc0 + 1;
    stage_tile<4, 8>(lds, Kg + (size_t)kc0 * 64 * INW, Vg + (size_t)kc0 * 64 * INW, wid, lane);
    for (int it = 0; it < NT; ++it) {
        asm volatile("s_waitcnt vmcnt(0) lgkmcnt(0)" ::: "memory"); __syncthreads();
        LAS unsigned char* cur = lds + (it & 1) * B_BUF; const int kc = kc0 + it;
        if (it + 1 < NT) stage_tile<4, 8>(lds + ((it + 1) & 1) * B_BUF, Kg + (size_t)(kc + 1) * 64 * INW, Vg + (size_t)(kc + 1) * 64 * INW, wid, lane);
        f32x16 p0, p1;
        qk_tile(p0, p1, (lds_cptr)cur + hl * 8192 + hi * 1024 + r32 * 16, qr);
        const int dist = c - kc; const LAS float* bh = bias + hl * 260;
        if (dist >= 3) { const float bc = bh[256];
#pragma unroll
            for (int r = 0; r < 16; ++r) { p0[r] += bc; p1[r] += bc; } }
        else { const int base = dist * 64 + half * 32 + r32 + 128;
#pragma unroll
            for (int r = 0; r < 16; ++r) { const int i0 = base - crow(r, hi), i1 = i0 - 32; p0[r] += bh[i0 > 256 ? 256 : i0]; p1[r] += bh[i1 > 256 ? 256 : i1]; } }
        softmax_pv<2, THR_L2>(p0, p1, o, m, l, (lds_cptr)cur + 4 * 8192 + (hl * 2) * 4096 + ((lane >> 4) & 1) * 32 + (lane & 3) * 8 + (4 * hi + ((lane & 15) >> 2)) * 64, wsf, r32, hi);
    }
    l += __shfl_xor(l, 32);
    if (hi == 0) wsf[r32] = 1.0f / l;
    asm volatile("s_waitcnt lgkmcnt(0)" ::: "memory");
    bf16_t* Yw = Y + (rowb + q0) * DM + 512 + h * 64 + r32;
#pragma unroll
    for (int r = 0; r < 16; ++r) { const float iv = wsf[crow(r, hi)];
#pragma unroll
        for (int db = 0; db < 2; ++db) Yw[(size_t)crow(r, hi) * DM + db * 32] = f2bf(o[db][r] * iv); }
    asm volatile("s_waitcnt lgkmcnt(0)" ::: "memory"); __syncthreads();
}
}

constexpr int NWAVES = 8;
#ifndef MK_N_LAUNCHES
#define MK_N_LAUNCHES 0
#endif
constexpr int N_PHASES = 13;

constexpr size_t MiB = 1u << 20;
constexpr size_t WS_CTL = 0, CTL_ZERO_BYTES = 1 * MiB;
constexpr size_t WS_WIN = 2 * MiB, WS_WO = 8 * MiB, WS_WMQ = 10 * MiB, WS_WMK = 12 * MiB, WS_WMV = 14 * MiB, WS_WMO = 16 * MiB, WS_WUP = 18 * MiB, WS_WDN = 26 * MiB;
constexpr size_t WS_COS = 34 * MiB, WS_SIN = 36 * MiB;
constexpr size_t WS_K2 = 38 * MiB, WS_V2T = 42 * MiB;
constexpr size_t WS_XB = 48 * MiB;
constexpr size_t WS_MB = 80 * MiB;
constexpr size_t WS_H = 84 * MiB;
constexpr size_t WS_Y = 180 * MiB;
constexpr size_t WS_Q2 = 84 * MiB, WS_P = 116 * MiB, WS_O2 = 148 * MiB;
constexpr size_t WS_HFF = 84 * MiB;
constexpr size_t WS_END = 212 * MiB;
constexpr int CW_TMO = 0, CW_BAR = 4096;

constexpr int RING_BYTES = 131072, MISC_OFF = 139264, LDS_BYTES = 147456;

typedef unsigned short bf16;
typedef unsigned v4u __attribute__((ext_vector_type(4)));
typedef float f32x4 __attribute__((ext_vector_type(4)));
typedef GAS unsigned gu32;
#define RLX_AGENT __ATOMIC_RELAXED, __HIP_MEMORY_SCOPE_AGENT
#define LDS_WAIT() asm volatile("s_waitcnt lgkmcnt(0)" ::: "memory")
#define VM_WAIT() asm volatile("s_waitcnt vmcnt(0)" ::: "memory")
__device__ __forceinline__ unsigned f2bf_u(float f) { unsigned u = __builtin_bit_cast(unsigned, f); return (u + 0x7fffu + ((u >> 16) & 1u)) >> 16; }
__device__ __forceinline__ unsigned pk2(float lo, float hi) { return f2bf_u(lo) | (f2bf_u(hi) << 16); }

#define XB_TMO      128
#define XB_XCNT(j)  (256  + 64 * (j))
#define XB_XSUB(j)  (1280 + 64 * (j))
#define XB_XGEN(j)  (2304 + 64 * (j))
#define XB_TOP      3328
#define XB_TOPGEN   3392
#define XCD_BAR_WORDS 3456
#define XB_SPIN_CAP (1u << 18)
__device__ __forceinline__ unsigned xb_ld(unsigned* p)              { return __hip_atomic_load(p, __ATOMIC_RELAXED, __HIP_MEMORY_SCOPE_AGENT); }
__device__ __forceinline__ unsigned xb_add(unsigned* p, unsigned v) { return __hip_atomic_fetch_add(p, v, __ATOMIC_RELAXED, __HIP_MEMORY_SCOPE_AGENT); }
__device__ __forceinline__ unsigned xb_xcc_id() { return (unsigned)__builtin_amdgcn_s_getreg((3 << 11) | 20) & 0xFu; }
#define XB_SPIN(cond, bar) do { unsigned _sp = 0; while (cond) { __builtin_amdgcn_s_sleep(1); \
    if ((++_sp & 255u) == 0u) { if (xb_ld(&(bar)[XB_TMO])) break; if (_sp > XB_SPIN_CAP) { atomicAdd(&(bar)[XB_TMO], 1u); break; } } } } while (0)
struct XcdBarrier { unsigned* bar; unsigned x; volatile LAS unsigned* st; };
__device__ __forceinline__ XcdBarrier xcd_barrier_post(unsigned* bar, volatile LAS unsigned* st) {
    XcdBarrier b; b.bar = bar; b.x = xb_xcc_id(); b.st = st;
    if (threadIdx.x == 0) (void)xb_add(&bar[XB_XCNT(b.x)], 1u);
    return b;
}
__device__ __forceinline__ void xcd_barrier_complete(unsigned* bar, unsigned x, unsigned& nloc, unsigned& nx) {
    const unsigned G = gridDim.x * gridDim.y * gridDim.z;
    unsigned sum, cnt, mine, sp = 0u;
    for (;;) {
        sum = 0u; cnt = 0u; mine = 0u;
#pragma unroll
        for (unsigned j = 0; j < 16; ++j) { const unsigned c = xb_ld(&bar[XB_XCNT(j)]); sum += c; cnt += (c > 0u) ? 1u : 0u; mine = (j == x) ? c : mine; }
        if (sum == G) break;
        __builtin_amdgcn_s_sleep(1);
        if ((++sp & 255u) == 0u) { if (xb_ld(&bar[XB_TMO])) break; if (sp > XB_SPIN_CAP) { atomicAdd(&bar[XB_TMO], 1u); break; } }
    }
    nloc = mine > 0u ? mine : 1u; nx = cnt > 0u ? cnt : 1u;
}
__device__ __forceinline__ void xcd_barrier(const XcdBarrier& b) {
    asm volatile("s_waitcnt vmcnt(0)" ::: "memory");
    __syncthreads();
    if (threadIdx.x == 0) {
        unsigned* bar = b.bar;
        __builtin_amdgcn_s_waitcnt(0);
        unsigned nloc = b.st[0], nx = b.st[1];
        if (nloc == 0u) { xcd_barrier_complete(bar, b.x, nloc, nx); b.st[0] = nloc; b.st[1] = nx; }
        const unsigned old = xb_add(&bar[XB_XSUB(b.x)], 1u);
        const unsigned gen = old / nloc;
        if (old + 1u == (gen + 1u) * nloc) {
            __builtin_amdgcn_fence(__ATOMIC_RELEASE, "agent");
            asm volatile("s_waitcnt vmcnt(0)" ::: "memory");
            const unsigned og = xb_add(&bar[XB_TOP], 1u);
            const unsigned tg = og / nx;
            if (og + 1u == (tg + 1u) * nx) xb_add(&bar[XB_TOPGEN], 1u);
            else XB_SPIN(xb_ld(&bar[XB_TOPGEN]) == tg, bar);
            __builtin_amdgcn_fence(__ATOMIC_ACQUIRE, "agent");
            xb_add(&bar[XB_XGEN(b.x)], 1u);
            asm volatile("s_waitcnt vmcnt(0)" ::: "memory");
        } else {
            XB_SPIN(xb_ld(&bar[XB_XGEN(b.x)]) == gen, bar);
            __builtin_amdgcn_fence(__ATOMIC_ACQUIRE, "agent");
            asm volatile("s_waitcnt vmcnt(0)" ::: "memory");
        }
    }
    __syncthreads();
}

struct Frame {
    LAS unsigned char* lds;
    int tid, lane, wave, vcu, G;
};

__device__ __forceinline__ float wave_sum(float v) {
#pragma unroll
    for (int o = 1; o < 64; o <<= 1) v += __shfl_xor(v, o);
    return v;
}
template <bool ROPE_PERM>
__device__ __forceinline__ void p0_transpose_item(const float* W, int K, int N, bf16* WT, LAS float* scr, int item, int lane) {
    const int nblk = N / 32, kb = item / nblk, nb = item % nblk, k0 = 64 * kb, n0 = 32 * nb;
    int nsrc = n0 + (lane & 31);
    if (ROPE_PERM) { const int np = nsrc & 63, g = np >> 3, e = np & 7; nsrc = (nsrc & ~63) + (e < 4 ? 4 * g + e : 32 + 4 * g + (e - 4)); }
#pragma unroll 8
    for (int i = 0; i < 32; ++i) { const int kk = 2 * i + (lane >> 5); scr[kk * 33 + (lane & 31)] = W[(size_t)(k0 + kk) * N + nsrc]; }
    LDS_WAIT(); asm volatile("" ::: "memory");
    const int c = lane & 7;
#pragma unroll
    for (int j = 0; j < 4; ++j) { const int n = (lane >> 3) + 8 * j; const LAS float* s = scr + (8 * c) * 33 + n;
        v4u o; o.x = pk2(s[0 * 33], s[1 * 33]); o.y = pk2(s[2 * 33], s[3 * 33]); o.z = pk2(s[4 * 33], s[5 * 33]); o.w = pk2(s[6 * 33], s[7 * 33]);
        *(GAS v4u*)(WT + (size_t)(n0 + n) * K + k0 + 8 * c) = o; }
    LDS_WAIT(); asm volatile("" ::: "memory");
}
__device__ __forceinline__ void row_to_bf16(const float* xrow, bf16* orow, int lane) {
    const GAS f32x4* xr = (const GAS f32x4*)xrow + lane; GAS unsigned long long* o8 = (GAS unsigned long long*)orow + lane;
#pragma unroll
    for (int j = 0; j < 4; ++j) { const f32x4 v = xr[64 * j]; o8[64 * j] = (unsigned long long)pk2(v.x, v.y) | ((unsigned long long)pk2(v.z, v.w) << 32); }
}
__device__ __forceinline__ void ln_row(float* io, bf16* ob, const float* g, const float* bb, int lane) {
    GAS f32x4* xr = (GAS f32x4*)io + lane;
    f32x4 v[4]; float s = 0.f;
#pragma unroll
    for (int j = 0; j < 4; ++j) { v[j] = xr[64 * j]; s += (v[j].x + v[j].y) + (v[j].z + v[j].w); }
    const float mean = wave_sum(s) * (1.f / DM); float s2 = 0.f;
#pragma unroll
    for (int j = 0; j < 4; ++j) { v[j] = v[j] - mean; s2 += (v[j].x * v[j].x + v[j].y * v[j].y) + (v[j].z * v[j].z + v[j].w * v[j].w); }
    const float rstd = 1.f / sqrtf(wave_sum(s2) * (1.f / DM) + LN_EPS);
#pragma unroll
    for (int j = 0; j < 4; ++j) { const f32x4 gg = ((const GAS f32x4*)g)[lane + 64 * j], b4 = ((const GAS f32x4*)bb)[lane + 64 * j];
        const f32x4 y = v[j] * rstd * gg + b4; xr[64 * j] = y;
        if (ob) ((GAS unsigned long long*)ob)[lane + 64 * j] = (unsigned long long)pk2(y.x, y.y) | ((unsigned long long)pk2(y.z, y.w) << 32); }
}

struct CrossOrder {
    int id, G; bool pv;
    __device__ __forceinline__ bool next(int i, pg8::Unit& u) const {
        const int L = i * G + id; if (L >= 256) return false;
        const int b = L >> 5, h = (L >> 3) & 3, qb = L & 7;
        u.pm = b * 8 + qb; u.pn = h;
        u.ao = ((size_t)(b * SEQ + qb * 256) * DM + h * 256) * 2;
        u.bo = pv ? ((size_t)(h * 256) * MMEM + b * NMEM) * 2
                  : ((size_t)(b * NMEM) * DM + h * 256) * 2;
        return true;
    }
    __device__ __forceinline__ void a_ready(const pg8::Unit&) const {}
    __device__ __forceinline__ void done(const pg8::Unit&) const {}
};

struct Args { const void* in[20]; float* out; unsigned char* ws; int ph_lo, ph_hi; };

__global__ void __launch_bounds__(NWAVES * 64, 2) layer_fwd(Args args) {
    extern __shared__ __attribute__((aligned(16))) unsigned char lds_raw[];
    Frame F;
    F.lds = (LAS unsigned char*)lds_raw;
    F.tid = threadIdx.x; F.lane = F.tid & 63; F.wave = __builtin_amdgcn_readfirstlane(F.tid >> 6);
    F.G = gridDim.x; { const int bx = blockIdx.x; F.vcu = (F.G % 8 == 0) ? (bx % 8) * (F.G / 8) + bx / 8 : bx; }
    unsigned char* ws = args.ws;
    gu32* ctl = (gu32*)(ws + WS_CTL);
    const float* x = (const float*)args.in[0]; const float* mem = (const float*)args.in[1]; const int* pos = (const int*)args.in[2];
    const float* w_in = (const float*)args.in[3]; const float* dlam = (const float*)args.in[4]; const float* subg = (const float*)args.in[5]; const float* relb = (const float*)args.in[6];
    const float* w_o = (const float*)args.in[7]; const float* ln1g = (const float*)args.in[8]; const float* ln1b = (const float*)args.in[9];
    const float* w_mq = (const float*)args.in[10]; const float* w_mk = (const float*)args.in[11]; const float* w_mv = (const float*)args.in[12]; const float* w_mo = (const float*)args.in[13];
    const float* ln2g = (const float*)args.in[14]; const float* ln2b = (const float*)args.in[15]; const float* w_up = (const float*)args.in[16]; const float* w_dn = (const float*)args.in[17];
    const float* ln3g = (const float*)args.in[18]; const float* ln3b = (const float*)args.in[19];
    float* out = args.out;
    bf16* WinT = (bf16*)(ws + WS_WIN); bf16* WoT = (bf16*)(ws + WS_WO); bf16* WmqT = (bf16*)(ws + WS_WMQ); bf16* WmkT = (bf16*)(ws + WS_WMK); bf16* WmvT = (bf16*)(ws + WS_WMV);
    bf16* WmoT = (bf16*)(ws + WS_WMO); bf16* WupT = (bf16*)(ws + WS_WUP); bf16* WdnT = (bf16*)(ws + WS_WDN);
    float* cosT = (float*)(ws + WS_COS); float* sinT = (float*)(ws + WS_SIN);
    bf16* K2 = (bf16*)(ws + WS_K2); bf16* V2T = (bf16*)(ws + WS_V2T); bf16* XB = (bf16*)(ws + WS_XB); bf16* MB = (bf16*)(ws + WS_MB);
    bf16* H = (bf16*)(ws + WS_H); bf16* Y = (bf16*)(ws + WS_Y); bf16* Q2 = (bf16*)(ws + WS_Q2); bf16* P = (bf16*)(ws + WS_P); bf16* O2 = (bf16*)(ws + WS_O2); bf16* HFF = (bf16*)(ws + WS_HFF);

    volatile LAS unsigned* MISC = (volatile LAS unsigned*)(F.lds + MISC_OFF);
    if (F.tid < 32) MISC[F.tid] = 0u;
    __syncthreads();
    XcdBarrier bar; bar.bar = (unsigned*)(ctl + CW_BAR); bar.x = 0; bar.st = nullptr;
    if (MK_N_LAUNCHES == 1) bar = xcd_barrier_post((unsigned*)(ctl + CW_BAR), MISC + 8);
    const int lo = args.ph_lo, hi = args.ph_hi;
#define IN(k) (lo <= (k) && (k) < hi)
#define SEAM(k) do { if (IN(k) && IN((k) + 1)) xcd_barrier(bar); } while (0)
    const int gw = F.vcu * NWAVES + F.wave, NGW = F.G * NWAVES;

    if (IN(0)) {
        LAS float* scr = (LAS float*)(F.lds + F.wave * 16384);
        constexpr int I_IN = (DM / 64) * (INW / 32), I_SQ = (DM / 64) * (DM / 32), I_UP = (DM / 64) * (DFF / 32), I_DN = (DFF / 64) * (DM / 32);
        constexpr int I_ROPE = (DM / 64) * (1024 / 32);
        constexpr int NITEMS = I_IN + 5 * I_SQ + I_UP + I_DN;
        for (int it = gw; it < NITEMS; it += NGW) {
            int r = it;
            if (r < I_IN) { const int nb = r % (INW / 32); if (nb < 32) p0_transpose_item<true>(w_in, DM, INW, WinT, scr, r, F.lane); else p0_transpose_item<false>(w_in, DM, INW, WinT, scr, r, F.lane); continue; } r -= I_IN;
            if (r < I_SQ) { p0_transpose_item<false>(w_o, DM, DM, WoT, scr, r, F.lane); continue; } r -= I_SQ;
            if (r < I_SQ) { p0_transpose_item<false>(w_mq, DM, DM, WmqT, scr, r, F.lane); continue; } r -= I_SQ;
            if (r < I_SQ) { p0_transpose_item<false>(w_mk, DM, DM, WmkT, scr, r, F.lane); continue; } r -= I_SQ;
            if (r < I_SQ) { p0_transpose_item<false>(w_mv, DM, DM, WmvT, scr, r, F.lane); continue; } r -= I_SQ;
            if (r < I_SQ) { p0_transpose_item<false>(w_mo, DM, DM, WmoT, scr, r, F.lane); continue; } r -= I_SQ;
            if (r < I_UP) { p0_transpose_item<false>(w_up, DM, DFF, WupT, scr, r, F.lane); continue; } r -= I_UP;
            p0_transpose_item<false>(w_dn, DFF, DM, WdnT, scr, r, F.lane);
        }
        (void)I_ROPE;
        for (int m = gw; m < MTOK; m += NGW) row_to_bf16(x + (size_t)m * DM, XB + (size_t)m * DM, F.lane);
        for (int m = gw; m < MMEM; m += NGW) row_to_bf16(mem + (size_t)m * DM, MB + (size_t)m * DM, F.lane);
        for (int e = F.vcu * 512 + F.tid; e < MTOK * 32; e += F.G * 512) { const int tok = e >> 5, i = e & 31;
            const float inv_freq = (float)(1.0 / pow(10000.0, (double)(2 * i) / 64.0));
            const float ang = (float)pos[tok] * inv_freq;
            cosT[e] = (float)cos((double)ang); sinT[e] = (float)sin((double)ang); }
    }
    SEAM(0);
    if (IN(1)) {
        { pg8::Gemm g{XB, WinT, DM, DM, DM}; pg8::StaticOrder S; S.init(MTOK, INW, DM, DM, F.G, (int)blockIdx.x);
          pg8::EpiInProj E{H, cosT, sinT};
          pg8::gemm_phase<pg8::EpiInProj, pg8::StaticOrder, true, true>(F.lds, g, S, E); }
        if ((int)blockIdx.x < 32) { pg8::Gemm g{MB, WmkT, DM, DM, DM}; pg8::StaticOrder S; S.init(MMEM, DM, DM, DM, 32, (int)blockIdx.x);
          pg8::EpiBf16<0> E{K2, DM, 1.f};
          pg8::gemm_phase<pg8::EpiBf16<0>, pg8::StaticOrder, true, true>(F.lds, g, S, E); }
        else if ((int)blockIdx.x < 64) { pg8::Gemm g{WmvT, MB, DM, DM, DM}; pg8::StaticOrder S; S.init(DM, MMEM, DM, DM, 32, (int)blockIdx.x - 32);
          pg8::EpiBf16<0> E{V2T, MMEM, 1.f};
          pg8::gemm_phase<pg8::EpiBf16<0>, pg8::StaticOrder, true, true>(F.lds, g, S, E); }
    }
    SEAM(1);
    if (IN(2)) {
        { const int v = F.vcu, b = v >> 5, hh = (v >> 3) & 3, s = v & 7;
          att::attnA_unit(b, hh, s, H, Y, dlam, subg, F.lds);
          att::attnA_unit(b, hh, 15 - s, H, Y, dlam, subg, F.lds); }
        { const int v = F.vcu, b = v >> 5, hg = (v >> 4) & 1, s = v & 15;
          att::attnB_unit(b, hg, s, H, Y, relb, F.lds);
          att::attnB_unit(b, hg, 31 - s, H, Y, relb, F.lds); }
    }
    SEAM(2);
    if (IN(3)) { pg8::Gemm g{Y, WoT, DM, DM, DM}; pg8::StaticOrder S; S.init(MTOK, DM, DM, DM, F.G, (int)blockIdx.x);
        pg8::EpiResF32 E{x, out, DM, ALPHA};
        pg8::gemm_phase<pg8::EpiResF32, pg8::StaticOrder, false, true>(F.lds, g, S, E); }
    SEAM(3);
    if (IN(4)) { for (int m = gw; m < MTOK; m += NGW) ln_row(out + (size_t)m * DM, XB + (size_t)m * DM, ln1g, ln1b, F.lane); }
    SEAM(4);
    if (IN(5)) { pg8::Gemm g{XB, WmqT, DM, DM, DM}; pg8::StaticOrder S; S.init(MTOK, DM, DM, DM, F.G, (int)blockIdx.x);
        pg8::EpiBf16<0> E{Q2, DM, C2_256};
        pg8::gemm_phase<pg8::EpiBf16<0>, pg8::StaticOrder, false, true>(F.lds, g, S, E); }
    SEAM(5);
    if (IN(6)) { pg8::Gemm g{Q2, K2, DM, DM, 256}; CrossOrder S{(int)blockIdx.x, (int)F.G, false};
        pg8::EpiSoftmaxP E{P, DM};
        pg8::gemm_phase<pg8::EpiSoftmaxP, CrossOrder, false, true>(F.lds, g, S, E); }
    SEAM(6);
    if (IN(7)) { pg8::Gemm g{P, V2T, DM, MMEM, 256}; CrossOrder S{(int)blockIdx.x, (int)F.G, true};
        pg8::EpiBf16<0> E{O2, DM, 1.f};
        pg8::gemm_phase<pg8::EpiBf16<0>, CrossOrder, false, true>(F.lds, g, S, E); }
    SEAM(7);
    if (IN(8)) { pg8::Gemm g{O2, WmoT, DM, DM, DM}; pg8::StaticOrder S; S.init(MTOK, DM, DM, DM, F.G, (int)blockIdx.x);
        pg8::EpiResF32 E{out, out, DM, ALPHA};
        pg8::gemm_phase<pg8::EpiResF32, pg8::StaticOrder, false, true>(F.lds, g, S, E); }
    SEAM(8);
    if (IN(9)) { for (int m = gw; m < MTOK; m += NGW) ln_row(out + (size_t)m * DM, XB + (size_t)m * DM, ln2g, ln2b, F.lane); }
    SEAM(9);
    if (IN(10)) { pg8::Gemm g{XB, WupT, DM, DM, DM}; pg8::StaticOrder S; S.init(MTOK, DFF, DM, DM, F.G, (int)blockIdx.x);
        pg8::EpiBf16<2> E{HFF, DFF, 1.f};
        pg8::gemm_phase<pg8::EpiBf16<2>, pg8::StaticOrder, true, true>(F.lds, g, S, E); }
    SEAM(10);
    if (IN(11)) { pg8::Gemm g{HFF, WdnT, DFF, DFF, DFF}; pg8::StaticOrder S; S.init(MTOK, DM, DFF, DFF, F.G, (int)blockIdx.x);
        pg8::EpiResF32 E{out, out, DM, ALPHA};
        pg8::gemm_phase<pg8::EpiResF32, pg8::StaticOrder, false, true>(F.lds, g, S, E); }
    SEAM(11);
    if (IN(12)) { for (int m = gw; m < MTOK; m += NGW) ln_row(out + (size_t)m * DM, nullptr, ln3g, ln3b, F.lane); }
#undef IN
#undef SEAM
}

extern "C" void kernel_launch(void* const* d_in, const int* in_sizes, int n_in, void* d_out, int out_size, void* d_ws, size_t ws_size, hipStream_t stream) {
    static int grid = 0;
    if (grid == 0) {
        if (n_in != 20 || in_sizes[0] != MTOK * DM || out_size != MTOK * DM || ws_size < WS_END) { fprintf(stderr, "kernel_launch: unexpected shapes (n_in %d, in0 %d, out %d, ws %zu); nothing launched\n", n_in, n_in > 0 ? in_sizes[0] : -1, out_size, ws_size); grid = -1; return; }
        int dev = 0, cus = 0;
        if (hipGetDevice(&dev) != hipSuccess || hipDeviceGetAttribute(&cus, hipDeviceAttributeMultiprocessorCount, dev) != hipSuccess) { grid = -1; return; }
        if (hipFuncSetAttribute((const void*)layer_fwd, hipFuncAttributeMaxDynamicSharedMemorySize, LDS_BYTES) != hipSuccess) { fprintf(stderr, "kernel_launch: hipFuncSetAttribute failed\n"); grid = -1; return; }
        (void)hipGetLastError();
        grid = cus;
        if (grid != 256) fprintf(stderr, "kernel_launch: %d CUs; this build assumes 256\n", grid);
    }
    if (grid < 0) return;
    (void)hipMemsetAsync((char*)d_ws + WS_CTL, 0, CTL_ZERO_BYTES, stream);
    Args a{};
    for (int i = 0; i < 20; ++i) a.in[i] = d_in[i];
    a.out = (float*)d_out; a.ws = (unsigned char*)d_ws;
    if (MK_N_LAUNCHES == 1) { a.ph_lo = 0; a.ph_hi = N_PHASES; hipLaunchKernelGGL(layer_fwd, dim3(grid), dim3(NWAVES * 64), LDS_BYTES, stream, a); }
    else for (int p = 0; p < N_PHASES; ++p) { a.ph_lo = p; a.ph_hi = p + 1; hipLaunchKernelGGL(layer_fwd, dim3(grid), dim3(NWAVES * 64), LDS_BYTES, stream, a); }
}
```
